# Optimizing an MI355X kernel written in HIP

```python
import math
import jax, jax.numpy as jnp
from jax import lax
import numpy as np

D_MODEL = 1024
BATCH = 16
SEQ = 256
DEPTH = 2
DEC_BATCH = 8
DEC_SEQ = 1024
PAST_LEN = 512

GRID_W = 64
N_MIXERS = 2
N_GLA_LAYERS = (DEPTH + 1) // 2
N_DIFF_LAYERS = DEPTH // 2
GLA_HEADS = 4
GLA_DK = D_MODEL // 2 // GLA_HEADS
GLA_DV = D_MODEL // GLA_HEADS
GLA_HK = GLA_HEADS * GLA_DK
GLA_HV = GLA_HEADS * GLA_DV
GLA_RANK = 16
GLA_TAU = 16.0
GLA_CHUNK = 64
DIFF_HEADS = 8
DIFF_DH = D_MODEL // DIFF_HEADS // 2
DIFF_DV = 2 * DIFF_DH
ROPE_THETA = 10000.0
Q_BLOCK = 128
D_FF = (((8 * D_MODEL + 2) // 3 + 255) // 256) * 256
EPS = 1e-6

kernel_name = 'hybrid_gla_diffattn_diffusion_step'


def rmsnorm(x, g):
    x32 = x.astype(jnp.float32)
    y = x32 * lax.rsqrt(jnp.mean(x32 * x32, axis=-1, keepdims=True) + EPS)
    return (y * g.astype(jnp.float32)).astype(x.dtype)


def adaln(cond, w, b):
    m = jax.nn.silu(cond) @ w + b
    return [t[..., None, :] for t in jnp.split(m, 6, axis=-1)]


def axial_rope(n_tokens, dim, dtype):
    rows = n_tokens // GRID_W
    r, col = jnp.meshgrid(jnp.arange(rows), jnp.arange(GRID_W), indexing='ij')
    r = r.reshape(-1).astype(jnp.float32)
    col = col.reshape(-1).astype(jnp.float32)
    n_freq = dim // 4
    inv = ROPE_THETA ** (-jnp.arange(n_freq, dtype=jnp.float32) / n_freq)
    ang = jnp.concatenate([r[:, None] * inv, col[:, None] * inv], axis=-1)
    return jnp.cos(ang).astype(dtype), jnp.sin(ang).astype(dtype)


def apply_rope(x, cos, sin):
    half = x.shape[-1] // 2
    x1, x2 = x[..., :half], x[..., half:]
    cs = cos[None, :, None, None, :]
    sn = sin[None, :, None, None, :]
    return jnp.concatenate([x1 * cs - x2 * sn, x2 * cs + x1 * sn], axis=-1)


def gla_scan(q, k, v, log_a, s0):
    B, T, H, DK = q.shape
    DV = v.shape[-1]
    C = min(GLA_CHUNK, T)
    N = T // C
    f32 = jnp.float32
    q = q.astype(f32).reshape(B, N, C, H, DK) * (DK ** -0.5)
    k = k.astype(f32).reshape(B, N, C, H, DK)
    v = v.astype(f32).reshape(B, N, C, H, DV)
    b = jnp.cumsum(log_a.reshape(B, N, C, H, DK), axis=2)
    b_last = b[:, :, -1]
    q_d = q * jnp.exp(b)
    k_d = k * jnp.exp(-b)
    k_end = k * jnp.exp(b_last[:, :, None] - b)
    mask = jnp.tril(jnp.ones((C, C), dtype=bool))
    A = jnp.where(mask, jnp.einsum('bnthd,bnshd->bnhts', q_d, k_d), 0.0)
    o_intra = jnp.einsum('bnhts,bnshv->bnthv', A, v)
    dS = jnp.einsum('bnshd,bnshv->bnhdv', k_end, v)
    decay = jnp.exp(b_last)

    def step(S, inp):
        dec, ds = inp
        return dec[..., None] * S + ds, S

    s_final, s_in = lax.scan(step, s0.astype(f32), (jnp.moveaxis(decay, 1, 0), jnp.moveaxis(dS, 1, 0)))
    s_in = jnp.moveaxis(s_in, 0, 1)
    o_inter = jnp.einsum('bnthd,bnhdv->bnthv', q_d, s_in)
    return (o_intra + o_inter).reshape(B, T, H, DV), s_final


def gla_mixer(h, s0f, s0b, w_in, w_g1, w_g2, b_g, g_head, w_out):
    B, T, _ = h.shape
    z = h @ w_in
    q = z[..., :GLA_HK].reshape(B, T, GLA_HEADS, GLA_DK)
    k = z[..., GLA_HK:2 * GLA_HK].reshape(B, T, GLA_HEADS, GLA_DK)
    v = z[..., 2 * GLA_HK:2 * GLA_HK + GLA_HV].reshape(B, T, GLA_HEADS, GLA_DV)
    r = z[..., 2 * GLA_HK + GLA_HV:]
    la_f = (jax.nn.log_sigmoid(((h @ w_g1[0]) @ w_g2[0] + b_g[0]).astype(jnp.float32)) / GLA_TAU).reshape(B, T, GLA_HEADS, GLA_DK)
    la_b = (jax.nn.log_sigmoid(((h @ w_g1[1]) @ w_g2[1] + b_g[1]).astype(jnp.float32)) / GLA_TAU).reshape(B, T, GLA_HEADS, GLA_DK)
    o_f, s_f = gla_scan(q, k, v, la_f, s0f)
    o_b, s_b = gla_scan(q[:, ::-1], k[:, ::-1], v[:, ::-1], la_b[:, ::-1], s0b)
    o = rmsnorm(o_f + o_b[:, ::-1], g_head).astype(h.dtype).reshape(B, T, GLA_HV)
    return (o * jax.nn.silu(r)) @ w_out, s_f, s_b


def diff_qkv(h, w_qkv):
    B, T, _ = h.shape
    z = h @ w_qkv
    q = z[..., :D_MODEL].reshape(B, T, DIFF_HEADS, 2, DIFF_DH)
    k = z[..., D_MODEL:2 * D_MODEL].reshape(B, T, DIFF_HEADS, 2, DIFF_DH)
    v = z[..., 2 * D_MODEL:].reshape(B, T, DIFF_HEADS, DIFF_DV)
    return q, k, v


def diff_lambda(lq, lk, lam_init):
    lq = lq.astype(jnp.float32)
    lk = lk.astype(jnp.float32)
    return jnp.exp(jnp.sum(lq[0] * lk[0])) - jnp.exp(jnp.sum(lq[1] * lk[1])) + lam_init


def diff_attend(q, k, v, lam):
    B, Tq = q.shape[:2]
    blk = min(Q_BLOCK, Tq)
    nb = Tq // blk
    qb = jnp.swapaxes(q.reshape(B, nb, blk, DIFF_HEADS, 2, DIFF_DH), 0, 1)

    def one(qi):
        s = jnp.einsum('bqhcd,bkhcd->bhcqk', qi, k).astype(jnp.float32) * (DIFF_DH ** -0.5)
        p = jax.nn.softmax(s, axis=-1)
        w = p[:, :, 0] - lam * p[:, :, 1]
        return jnp.einsum('bhqk,bkhv->bqhv', w.astype(v.dtype), v)

    o = lax.map(one, qb)
    return jnp.swapaxes(o, 0, 1).reshape(B, Tq, DIFF_HEADS, DIFF_DV)


def diff_out(o, g_head, w_out, lam_init):
    B, T = o.shape[:2]
    o = rmsnorm(o, g_head) * (1.0 - lam_init)
    return o.reshape(B, T, DIFF_HEADS * DIFF_DV) @ w_out


def swiglu(h, wg, wu, wd):
    return (jax.nn.silu(h @ wg) * (h @ wu)) @ wd


def setup_inputs(seed: int = 0) -> dict:
    key = jax.random.key(seed)
    ks = iter(jax.random.split(key, 40))
    f32 = jnp.float32

    def nrm(shape, scale):
        return jax.random.normal(next(ks), shape, f32) * scale

    D = D_MODEL
    NG, ND = N_GLA_LAYERS, N_DIFF_LAYERS
    return {
        'x_prompt': nrm((BATCH, SEQ, D), 1.0),
        'x_sample': nrm((DEC_BATCH, DEC_SEQ, D), 1.0),
        'state_gla_fwd': nrm((DEC_BATCH, NG, GLA_HEADS, GLA_DK, GLA_DV), 1.0),
        'state_gla_bwd': nrm((DEC_BATCH, NG, GLA_HEADS, GLA_DK, GLA_DV), 1.0),
        'cache_diff_k': nrm((DEC_BATCH, ND, PAST_LEN, DIFF_HEADS, 2, DIFF_DH), 1.0),
        'cache_diff_v': nrm((DEC_BATCH, ND, PAST_LEN, DIFF_HEADS, DIFF_DV), 1.0),
        'c': nrm((DEC_BATCH, D), 1.0),
        'c_ctx': nrm((D,), 1.0),
        'w_ada': nrm((DEPTH, D, 6 * D), 0.5 * D ** -0.5),
        'b_ada': nrm((DEPTH, 6 * D), 0.01),
        'g_mix_norm': 1.0 + nrm((DEPTH, D), 0.02),
        'g_ffn_norm': 1.0 + nrm((DEPTH, D), 0.02),
        'w_gla_in': nrm((NG, D, 2 * GLA_HK + 2 * GLA_HV), D ** -0.5),
        'w_gla_g1': nrm((NG, 2, D, GLA_RANK), D ** -0.5),
        'w_gla_g2': nrm((NG, 2, GLA_RANK, GLA_HK), GLA_RANK ** -0.5),
        'b_gla_g': nrm((NG, 2, GLA_HK), 0.1),
        'g_gla_head': 1.0 + nrm((NG, GLA_DV), 0.02),
        'w_gla_out': nrm((NG, GLA_HV, D), GLA_HV ** -0.5),
        'w_diff_qkv': nrm((ND, D, 3 * D), D ** -0.5),
        'lam_q': nrm((ND, 2, DIFF_DH), 0.1),
        'lam_k': nrm((ND, 2, DIFF_DH), 0.1),
        'g_diff_head': 1.0 + nrm((ND, DIFF_DV), 0.02),
        'w_diff_out': nrm((ND, DIFF_HEADS * DIFF_DV, D), (DIFF_HEADS * DIFF_DV) ** -0.5),
        'w_ffn_gate': nrm((DEPTH, D, D_FF), D ** -0.5),
        'w_ffn_up': nrm((DEPTH, D, D_FF), D ** -0.5),
        'w_ffn_down': nrm((DEPTH, D_FF, D), D_FF ** -0.5),
        'g_final': 1.0 + nrm((D,), 0.02),
    }


def reference(x_prompt, x_sample, state_gla_fwd, state_gla_bwd, cache_diff_k, cache_diff_v, c, c_ctx,
              w_ada, b_ada, g_mix_norm, g_ffn_norm, w_gla_in, w_gla_g1, w_gla_g2, b_gla_g, g_gla_head,
              w_gla_out, w_diff_qkv, lam_q, lam_k, g_diff_head, w_diff_out, w_ffn_gate, w_ffn_up,
              w_ffn_down, g_final):
    xp, xs = x_prompt, x_sample
    bp = xp.shape[0]
    cos, sin = axial_rope(xs.shape[1], DIFF_DH, xs.dtype)
    new_f, new_b, new_k, new_v = [], [], [], []
    for i in range(DEPTH):
        mp = adaln(c_ctx, w_ada[i], b_ada[i])
        ms = adaln(c, w_ada[i], b_ada[i])
        hp = rmsnorm(xp, g_mix_norm[i]) * (1 + mp[1]) + mp[0]
        hs = rmsnorm(xs, g_mix_norm[i]) * (1 + ms[1]) + ms[0]
        j = i // N_MIXERS
        if i % N_MIXERS == 0:
            gp = (w_gla_in[j], w_gla_g1[j], w_gla_g2[j], b_gla_g[j], g_gla_head[j], w_gla_out[j])
            zero = jnp.zeros((bp, GLA_HEADS, GLA_DK, GLA_DV), jnp.float32)
            op, s_f, s_b = gla_mixer(hp, zero, zero, *gp)
            os_, _, _ = gla_mixer(hs, state_gla_fwd[:, j], state_gla_bwd[:, j], *gp)
            new_f.append(s_f.astype(xp.dtype))
            new_b.append(s_b.astype(xp.dtype))
        else:
            lam_init = 0.8 - 0.6 * math.exp(-0.3 * i)
            lam = diff_lambda(lam_q[j], lam_k[j], lam_init)
            qp, kp, vp = diff_qkv(hp, w_diff_qkv[j])
            qs, ks, vs = diff_qkv(hs, w_diff_qkv[j])
            qs = apply_rope(qs, cos, sin)
            ks = apply_rope(ks, cos, sin)
            op = diff_out(diff_attend(qp, kp, vp, lam), g_diff_head[j], w_diff_out[j], lam_init)
            k_all = jnp.concatenate([cache_diff_k[:, j].astype(ks.dtype), ks], axis=1)
            v_all = jnp.concatenate([cache_diff_v[:, j].astype(vs.dtype), vs], axis=1)
            os_ = diff_out(diff_attend(qs, k_all, v_all, lam), g_diff_head[j], w_diff_out[j], lam_init)
            new_k.append(kp)
            new_v.append(vp)
        xp = xp + mp[2] * op
        xs = xs + ms[2] * os_
        hp = rmsnorm(xp, g_ffn_norm[i]) * (1 + mp[4]) + mp[3]
        hs = rmsnorm(xs, g_ffn_norm[i]) * (1 + ms[4]) + ms[3]
        xp = xp + mp[5] * swiglu(hp, w_ffn_gate[i], w_ffn_up[i], w_ffn_down[i])
        xs = xs + ms[5] * swiglu(hs, w_ffn_gate[i], w_ffn_up[i], w_ffn_down[i])
    y_prompt = rmsnorm(xp, g_final)
    y_sample = rmsnorm(xs, g_final)
    new_state_gla_fwd = jnp.stack(new_f, axis=1)
    new_state_gla_bwd = jnp.stack(new_b, axis=1)
    new_cache_diff_k = jnp.stack(new_k, axis=1)
    new_cache_diff_v = jnp.stack(new_v, axis=1)
    return (y_prompt, y_sample, new_state_gla_fwd, new_state_gla_bwd, new_cache_diff_k, new_cache_diff_v)
```

```cpp
#define MK_PER_PHASE 1
#include <hip/hip_runtime.h>
#include <cstdio>
#include <cstdint>
namespace pg8 {
#define PG8_LAS __attribute__((address_space(3)))
typedef unsigned short bf16_t;
typedef short bf16x8 __attribute__((ext_vector_type(8)));
typedef float f32x4 __attribute__((ext_vector_type(4)));
typedef unsigned u32x4 __attribute__((ext_vector_type(4)));
constexpr int BM = 256, BK = 64, HALF = 128, HTB = HALF * BK * 2  , STAGE_BYTES = 8 * HTB, NXCD = 8, WGM = 8;

__host__ __device__ __forceinline__ int lds_byte(int r, int c) { const int st = (r >> 4) * 2 + (c >> 5), rr = r & 15, cc = c & 31, ob = rr * 64 + cc * 2; return st * 1024 + (ob ^ (((ob >> 9) & 1) << 5)); }
__host__ __device__ __forceinline__ void stage_rc(int b, int& R, int& C) { const int st = b / 1024, sb = b % 1024, swz = sb ^ (((sb >> 9) & 1) << 5); R = (st >> 1) * 16 + swz / 64; C = (st & 1) * 32 + (swz % 64) / 2; }
__host__ __device__ __forceinline__ int perm32(int rho) { const int n = rho >> 4, i = rho & 15; return 8 * (i >> 2) + 4 * n + (i & 3); }

struct Unit { int pm, pn; };
struct Gemm { const bf16_t* A; const bf16_t* Bt; int M, N, K; };

struct StaticOrder {
    int nM, nN, nwg, G, c;
    __host__ __device__ void init(int M, int N, int G_, int c_) { nM = M / BM; nN = N / BM; nwg = nM * nN; G = G_; c = c_; }
    __host__ __device__ bool next(int i, Unit& u) const {
        const long L = (long)i * G + c; if (L >= nwg) return false;
        int wgid = (int)L; { const int q = nwg / NXCD, r = nwg % NXCD, xcd = wgid % NXCD, off = wgid / NXCD; wgid = (xcd < r ? xcd * (q + 1) : r * (q + 1) + (xcd - r) * q) + off; }
        const int nig = WGM * nN, gid = wgid / nig, fm = gid * WGM, gsz = (nM - fm) < WGM ? (nM - fm) : WGM;
        u.pm = fm + ((wgid % nig) % gsz); u.pn = (wgid % nig) / gsz; return true;
    }
    __device__ __forceinline__ void a_ready(const Unit&) const {}
    __device__ __forceinline__ void done(const Unit&) const {}
};

__device__ __forceinline__ unsigned cvt_pk_bf16(float lo, float hi) { unsigned r; asm volatile("v_cvt_pk_bf16_f32 %0, %1, %2" : "=v"(r) : "v"(lo), "v"(hi)); return r; }
typedef unsigned u32x2 __attribute__((ext_vector_type(2)));
constexpr int EP_D = 1024, EP_NMOD = 6144;
__device__ __forceinline__ int ep_cond(int pm) { return pm < 16 ? 0 : 1 + ((pm - 16) >> 2); }

struct EpiInProj {
    static constexpr bool PERM = true, AFTER_DRAIN = false;
    bf16_t* Z; float* G1;
    __device__ __forceinline__ void operator()(const f32x4 (&acc)[2][2][4][2], const Unit& u, int wr, int wc, int fr, int fq) const {
        const int row0 = u.pm * BM + wr * 64 + fr;
        if (u.pn == 12) {
            if (wc == 0) {
#pragma unroll
                for (int ai = 0; ai < 2; ++ai)
#pragma unroll
                    for (int m = 0; m < 4; ++m) { float* p = G1 + (size_t)(row0 + ai * HALF + m * 16) * 32 + 8 * fq;
                        *(f32x4*)p = acc[ai][0][m][0]; *(f32x4*)(p + 4) = acc[ai][0][m][1]; }
            }
            return;
        }
        const int col0 = u.pn * BM + wc * 32 + 8 * fq;
#pragma unroll
        for (int ai = 0; ai < 2; ++ai)
#pragma unroll
            for (int m = 0; m < 4; ++m) { bf16_t* rowp = Z + (size_t)(row0 + ai * HALF + m * 16) * 3072 + col0;
#pragma unroll
                for (int bj = 0; bj < 2; ++bj) { const f32x4 v0 = acc[ai][bj][m][0], v1 = acc[ai][bj][m][1];
                    u32x4 w; w.x = cvt_pk_bf16(v0[0], v0[1]); w.y = cvt_pk_bf16(v0[2], v0[3]); w.z = cvt_pk_bf16(v1[0], v1[1]); w.w = cvt_pk_bf16(v1[2], v1[3]);
                    *(u32x4*)(rowp + bj * HALF) = w; } }
    }
};

struct EpiRes {
    static constexpr bool PERM = false, AFTER_DRAIN = false;
    const float* base_p; const float* base_s; float* out; const float* gate;
    __device__ __forceinline__ void operator()(const f32x4 (&acc)[2][2][4][2], const Unit& u, int wr, int wc, int fr, int fq) const {
        const float* g = gate + (size_t)ep_cond(u.pm) * EP_NMOD;
        const float* base = u.pm < 16 ? base_p + (size_t)u.pm * BM * EP_D : base_s + (size_t)(u.pm - 16) * BM * EP_D;
        float* o = out + (size_t)u.pm * BM * EP_D;
        const int col0 = u.pn * BM + wc * 32 + 4 * fq;
        f32x4 gv[2][2];
#pragma unroll
        for (int bj = 0; bj < 2; ++bj)
#pragma unroll
            for (int n = 0; n < 2; ++n) gv[bj][n] = *(const f32x4*)(g + col0 + bj * HALF + n * 16);
#pragma unroll
        for (int ai = 0; ai < 2; ++ai)
#pragma unroll
            for (int m = 0; m < 4; ++m) { const size_t off = (size_t)(ai * HALF + wr * 64 + m * 16 + fr) * EP_D + col0;
#pragma unroll
                for (int bj = 0; bj < 2; ++bj)
#pragma unroll
                    for (int n = 0; n < 2; ++n) { const f32x4 b = *(const f32x4*)(base + off + bj * HALF + n * 16);
                        *(f32x4*)(o + off + bj * HALF + n * 16) = b + gv[bj][n] * acc[ai][bj][m][n]; } }
    }
};

struct EpiSwiglu {
    static constexpr bool PERM = true, AFTER_DRAIN = false;
    bf16_t* ACT;
    __device__ __forceinline__ void operator()(const f32x4 (&acc)[2][2][4][2], const Unit& u, int wr, int wc, int fr, int fq) const {
        const int row0 = u.pm * BM + wr * 64 + fr, hid0 = u.pn * 128 + wc * 16 + 4 * fq;
#pragma unroll
        for (int ai = 0; ai < 2; ++ai)
#pragma unroll
            for (int m = 0; m < 4; ++m) { bf16_t* rowp = ACT + (size_t)(row0 + ai * HALF + m * 16) * 2816 + hid0;
#pragma unroll
                for (int bj = 0; bj < 2; ++bj) { const f32x4 g = acc[ai][bj][m][0], up = acc[ai][bj][m][1]; f32x4 a;
#pragma unroll
                    for (int i = 0; i < 4; ++i) a[i] = g[i] * __builtin_amdgcn_rcpf(1.0f + __builtin_amdgcn_exp2f(-1.4426950408889634f * g[i])) * up[i];
                    u32x2 w; w.x = cvt_pk_bf16(a[0], a[1]); w.y = cvt_pk_bf16(a[2], a[3]);
                    *(u32x2*)(rowp + bj * 64) = w; } }
    }
};

struct EpiQkv {
    static constexpr bool PERM = false, AFTER_DRAIN = false;
    bf16_t* Q; bf16_t* KB; bf16_t* VB; float* nck; float* ncv; const float* COS; const float* SIN; float c2;
    __device__ __forceinline__ void operator()(const f32x4 (&acc)[2][2][4][2], const Unit& u, int wr, int wc, int fr, int fq) const {
        const int sect = u.pn >> 2, ct = (u.pn & 3) * BM;
        const bool prompt = u.pm < 16;
        const int sb = (u.pm - 16) >> 2, t0 = ((u.pm - 16) & 3) * BM;
        const size_t kvrow0 = prompt ? (size_t)u.pm * BM : (size_t)4096 + (size_t)sb * 1536 + 512 + t0;
        const unsigned rl0 = wr * 64 + fr;
        if (sect == 2) {
            bf16_t* const db = VB + kvrow0 * EP_D; float* const df = ncv + (size_t)u.pm * BM * EP_D;
            const unsigned lo = rl0 * EP_D + ct + wc * 32 + 4 * fq;
#pragma unroll
            for (int ai = 0; ai < 2; ++ai)
#pragma unroll
                for (int m = 0; m < 4; ++m) { const unsigned lr = lo + (ai * HALF + m * 16) * EP_D;
#pragma unroll
                    for (int bj = 0; bj < 2; ++bj)
#pragma unroll
                        for (int n = 0; n < 2; ++n) { const f32x4 v = acc[ai][bj][m][n]; const unsigned off = lr + bj * HALF + n * 16;
                            u32x2 w; w.x = cvt_pk_bf16(v[0], v[1]); w.y = cvt_pk_bf16(v[2], v[3]);
                            *(u32x2*)(db + off) = w;
                            if (prompt) *(f32x4*)(df + off) = v; }
                    asm volatile("" ::: "memory"); }
            return;
        }
        const unsigned e0 = 16 * (wc & 1) + 4 * fq;
        const unsigned lo = rl0 * EP_D + ct + 64 * (wc >> 1) + e0, lcs = rl0 * 32 + e0;
        bf16_t* const db = sect == 0 ? Q + (size_t)u.pm * BM * EP_D : KB + kvrow0 * EP_D; float* const df = nck + (size_t)u.pm * BM * EP_D;
        const float* const cp = COS + (size_t)(prompt ? 0 : t0) * 32; const float* const sp = SIN + (size_t)(prompt ? 0 : t0) * 32;
        const float sc = sect == 0 ? c2 : 1.0f; const bool wf = prompt && sect == 1;
#pragma unroll
        for (int ai = 0; ai < 2; ++ai)
#pragma unroll
            for (int m = 0; m < 4; ++m) { const unsigned lr = lo + (ai * HALF + m * 16) * EP_D;
                f32x4 cs = *(const f32x4*)(cp + lcs + (ai * HALF + m * 16) * 32), sn = *(const f32x4*)(sp + lcs + (ai * HALF + m * 16) * 32);
                if (prompt) { cs = (f32x4){1.f, 1.f, 1.f, 1.f}; sn = (f32x4){0.f, 0.f, 0.f, 0.f}; }
#pragma unroll
                for (int bj = 0; bj < 2; ++bj) { const f32x4 x1 = acc[ai][bj][m][0], x2 = acc[ai][bj][m][1];
                    const f32x4 o1 = (x1 * cs - x2 * sn) * sc, o2 = (x2 * cs + x1 * sn) * sc; const unsigned off = lr + bj * HALF;
                    u32x2 w1, w2; w1.x = cvt_pk_bf16(o1[0], o1[1]); w1.y = cvt_pk_bf16(o1[2], o1[3]); w2.x = cvt_pk_bf16(o2[0], o2[1]); w2.y = cvt_pk_bf16(o2[2], o2[3]);
                    *(u32x2*)(db + off) = w1; *(u32x2*)(db + off + 32) = w2;
                    if (wf) { *(f32x4*)(df + off) = o1; *(f32x4*)(df + off + 32) = o2; } }
                asm volatile("" ::: "memory"); }
    }
};
template <class Epi, class Sched, bool ALIGN_EPI = false, bool SP2 = false>
__device__ __forceinline__ void gemm_phase(PG8_LAS unsigned char* lds, const Gemm g, const Sched& S, const Epi& E) {
    const int tid = threadIdx.x, wid = __builtin_amdgcn_readfirstlane(tid >> 6), lane = tid & 63, wr = wid >> 2, wc = wid & 3, fr = lane & 15, fq = lane >> 4;
    const int K = g.K, nt = K / BK;
    unsigned voffA[2], voffB[2];
#pragma unroll
    for (int i = 0; i < 2; ++i) { int R, C; stage_rc(tid * 16 + i * 8192, R, C); const int Rb = Epi::PERM ? ((R & ~31) + perm32(R & 31)) : R;
        voffA[i] = (unsigned)(R * K + C) * 2u; voffB[i] = (unsigned)(Rb * K + C) * 2u; }
    const size_t kstep = (size_t)(BK * 2);
    const size_t hstep = (size_t)HALF * K * 2;
    const size_t tstep = 2 * hstep;
    const unsigned ldsw = (unsigned)wid * 1024u;
    const int aoff = lds_byte(wr * 64 + fr, fq * 8), boff = lds_byte(wc * 32 + fr, fq * 8);
#define PG8_SA(b, h) (((b) * 2 + (h)) * HTB)
#define PG8_SB(b, h) ((4 + (b) * 2 + (h)) * HTB)
#define PG8_STAGE(bufoff, gbase, voff) do { _Pragma("unroll") for (int _i = 0; _i < 2; ++_i) \
        __builtin_amdgcn_global_load_lds((const unsigned*)((const char*)(gbase) + (voff)[_i]), (PG8_LAS unsigned*)(lds + (bufoff) + ldsw + _i * 8192), 16, 0, 0); } while (0)
#define PG8_LDA(dst, b, h) do { _Pragma("unroll") for (int m = 0; m < 4; ++m) _Pragma("unroll") for (int k = 0; k < 2; ++k) dst[m][k] = *(const PG8_LAS bf16x8*)(lds + PG8_SA(b, h) + aoff + m * 2048 + k * 1024); } while (0)
#define PG8_LDB(dst, b, h) do { _Pragma("unroll") for (int n = 0; n < 2; ++n) _Pragma("unroll") for (int k = 0; k < 2; ++k) dst[n][k] = *(const PG8_LAS bf16x8*)(lds + PG8_SB(b, h) + boff + n * 2048 + k * 1024); } while (0)
#define PG8_MMA(ai, bj, At, Bt) do { __builtin_amdgcn_s_setprio(1); _Pragma("unroll") for (int m = 0; m < 4; ++m) _Pragma("unroll") for (int n = 0; n < 2; ++n) _Pragma("unroll") for (int k = 0; k < 2; ++k) \
        acc[ai][bj][m][n] = __builtin_amdgcn_mfma_f32_16x16x32_bf16(Bt[n][k], At[m][k], acc[ai][bj][m][n], 0, 0, 0); __builtin_amdgcn_s_setprio(0); } while (0)
#define PG8_WAIT_V(n) asm volatile("s_waitcnt vmcnt(" #n ")" ::: "memory")
#define PG8_WAIT_L(n) asm volatile("s_waitcnt lgkmcnt(" #n ")" ::: "memory")
#define PG8_BAR __builtin_amdgcn_s_barrier()
#define PG8_SCHED __builtin_amdgcn_sched_barrier(0)
    Unit cur, nxt; int ui = 0;
    if (!S.next(0, cur)) return;
    f32x4 acc[2][2][4][2];
#pragma unroll
    for (int a = 0; a < 2; ++a)
#pragma unroll
        for (int b = 0; b < 2; ++b)
#pragma unroll
            for (int m = 0; m < 4; ++m)
#pragma unroll
                for (int n = 0; n < 2; ++n) acc[a][b][m][n] = (f32x4){0.f, 0.f, 0.f, 0.f};
    bf16x8 At[4][2], B0[2][2], B1[2][2];
    const char* cA = (const char*)g.A + (size_t)cur.pm * tstep; const char* cB = (const char*)g.Bt + (size_t)cur.pn * tstep;
    S.a_ready(cur);
    if constexpr (SP2) {
        PG8_STAGE(PG8_SB(0, 0), cB, voffB); PG8_STAGE(PG8_SB(0, 1), cB + hstep, voffB); PG8_STAGE(PG8_SA(0, 0), cA, voffA); PG8_STAGE(PG8_SA(0, 1), cA + hstep, voffA);
        if (wr == 1) PG8_BAR;
        PG8_WAIT_V(2); PG8_BAR;
        PG8_STAGE(PG8_SB(1, 0), cB + kstep, voffB); PG8_STAGE(PG8_SA(1, 0), cA + kstep, voffA); PG8_STAGE(PG8_SB(1, 1), cB + hstep + kstep, voffB);
        PG8_WAIT_V(6); PG8_BAR;
    } else {
        PG8_STAGE(PG8_SB(0, 0), cB, voffB); PG8_STAGE(PG8_SA(0, 0), cA, voffA); PG8_STAGE(PG8_SB(0, 1), cB + hstep, voffB); PG8_STAGE(PG8_SA(0, 1), cA + hstep, voffA);
        if (wr == 1) PG8_BAR;
        PG8_WAIT_V(4); PG8_BAR;
        PG8_STAGE(PG8_SB(1, 0), cB + kstep, voffB); PG8_STAGE(PG8_SA(1, 0), cA + kstep, voffA); PG8_STAGE(PG8_SB(1, 1), cB + hstep + kstep, voffB);
        PG8_WAIT_V(6); PG8_BAR;
    }
    for (;;) {
        const bool has_next = S.next(ui + 1, nxt);
        const char* nA = has_next ? (const char*)g.A + (size_t)nxt.pm * tstep : cA; const char* nB = has_next ? (const char*)g.Bt + (size_t)nxt.pn * tstep : cB;
        for (int t = 0; t < nt; t += 2) {
            const bool last = (t == nt - 2);
            const char* a1 = cA + (size_t)(t + 1) * kstep;
            const char* a2 = last ? nA : cA + (size_t)(t + 2) * kstep; const char* b2 = last ? nB : cB + (size_t)(t + 2) * kstep;
            const char* a3 = a2 + kstep; const char* b3 = b2 + kstep;
            if (last && has_next) S.a_ready(nxt);
            if constexpr (SP2) {
            PG8_LDB(B0, 0, 0); PG8_LDB(B1, 0, 1); PG8_SCHED; PG8_LDA(At, 0, 0); PG8_STAGE(PG8_SA(1, 1), a1 + hstep, voffA);
            PG8_WAIT_V(8); PG8_WAIT_L(0); PG8_BAR; PG8_MMA(0, 0, At, B0); PG8_MMA(0, 1, At, B1); PG8_BAR; PG8_SCHED;
            PG8_LDA(At, 0, 1); PG8_STAGE(PG8_SB(0, 0), b2, voffB); PG8_STAGE(PG8_SB(0, 1), b2 + hstep, voffB); PG8_STAGE(PG8_SA(0, 0), a2, voffA);
            PG8_WAIT_V(8); PG8_WAIT_L(0); PG8_BAR; PG8_MMA(1, 0, At, B0); PG8_MMA(1, 1, At, B1); PG8_BAR; PG8_SCHED;
            PG8_LDB(B0, 1, 0); PG8_LDB(B1, 1, 1); PG8_SCHED; PG8_LDA(At, 1, 0); PG8_STAGE(PG8_SA(0, 1), a2 + hstep, voffA);
            PG8_WAIT_V(8); PG8_WAIT_L(0); PG8_BAR; PG8_MMA(0, 0, At, B0); PG8_MMA(0, 1, At, B1); PG8_BAR; PG8_SCHED;
            PG8_LDA(At, 1, 1); PG8_STAGE(PG8_SB(1, 0), b3, voffB); PG8_STAGE(PG8_SB(1, 1), b3 + hstep, voffB); PG8_STAGE(PG8_SA(1, 0), a3, voffA);
            PG8_WAIT_V(8); PG8_WAIT_L(0); PG8_BAR; PG8_MMA(1, 0, At, B0); PG8_MMA(1, 1, At, B1); PG8_BAR; PG8_SCHED;
            } else {
            PG8_LDB(B0, 0, 0); PG8_SCHED; PG8_LDA(At, 0, 0); PG8_STAGE(PG8_SA(1, 1), a1 + hstep, voffA);
            PG8_WAIT_L(8); PG8_BAR; PG8_WAIT_L(0); PG8_MMA(0, 0, At, B0); PG8_BAR; PG8_SCHED;
            PG8_LDB(B1, 0, 1); PG8_STAGE(PG8_SB(0, 0), b2, voffB);
            PG8_BAR; PG8_WAIT_L(0); PG8_MMA(0, 1, At, B1); PG8_BAR;
            PG8_LDA(At, 0, 1); PG8_STAGE(PG8_SA(0, 0), a2, voffA);
            PG8_BAR; PG8_WAIT_L(0); PG8_MMA(1, 0, At, B0); PG8_BAR; PG8_SCHED;
            PG8_STAGE(PG8_SB(0, 1), b2 + hstep, voffB);
            PG8_WAIT_V(6); PG8_BAR; PG8_MMA(1, 1, At, B1); PG8_BAR;
            PG8_LDB(B0, 1, 0); PG8_SCHED; PG8_LDA(At, 1, 0); PG8_STAGE(PG8_SA(0, 1), a2 + hstep, voffA);
            PG8_WAIT_L(8); PG8_BAR; PG8_WAIT_L(0); PG8_MMA(0, 0, At, B0); PG8_BAR; PG8_SCHED;
            PG8_LDB(B1, 1, 1); PG8_STAGE(PG8_SB(1, 0), b3, voffB);
            PG8_BAR; PG8_WAIT_L(0); PG8_MMA(0, 1, At, B1); PG8_BAR;
            PG8_LDA(At, 1, 1); PG8_STAGE(PG8_SA(1, 0), a3, voffA);
            PG8_BAR; PG8_WAIT_L(0); PG8_MMA(1, 0, At, B0); PG8_BAR; PG8_SCHED;
            PG8_STAGE(PG8_SB(1, 1), b3 + hstep, voffB);
            PG8_WAIT_V(6); PG8_BAR; PG8_MMA(1, 1, At, B1); PG8_BAR;
            }
        }
        if constexpr (ALIGN_EPI) { if (wr == 0) PG8_BAR; }
        if constexpr (!Epi::AFTER_DRAIN) { E(acc, cur, wr, wc, fr, fq); S.done(cur); }
        if (!has_next) break;
#pragma unroll
        for (int a = 0; a < 2; ++a)
#pragma unroll
            for (int b = 0; b < 2; ++b)
#pragma unroll
                for (int m = 0; m < 4; ++m)
#pragma unroll
                    for (int n = 0; n < 2; ++n) acc[a][b][m][n] = (f32x4){0.f, 0.f, 0.f, 0.f};
        cur = nxt; cA = nA; cB = nB; ++ui;
        if constexpr (ALIGN_EPI) { if (wr == 1) PG8_BAR; }
    }
    PG8_WAIT_V(0);
    if constexpr (!ALIGN_EPI) { if (wr == 0) PG8_BAR; }
    PG8_BAR;
    if constexpr (Epi::AFTER_DRAIN) { E.fused(acc, cur, wr, wc, fr, fq, lds, wid, lane); S.done(cur); }
#undef PG8_SA
#undef PG8_SB
#undef PG8_STAGE
#undef PG8_LDA
#undef PG8_LDB
#undef PG8_MMA
#undef PG8_WAIT_V
#undef PG8_WAIT_L
#undef PG8_BAR
#undef PG8_SCHED
}
}
#define GAS __attribute__((address_space(1)))
#define LAS __attribute__((address_space(3)))
typedef unsigned short bf16;
typedef unsigned v4u __attribute__((ext_vector_type(4)));
typedef float f32x4 __attribute__((ext_vector_type(4)));
typedef short bf16x8 __attribute__((ext_vector_type(8)));
typedef GAS unsigned gu32;
typedef GAS unsigned long long gu64;
#define RLX_AGENT __ATOMIC_RELAXED, __HIP_MEMORY_SCOPE_AGENT
#define LDS_WAIT() asm volatile("s_waitcnt lgkmcnt(0)" ::: "memory")
#define VM_WAIT() asm volatile("s_waitcnt vmcnt(0)" ::: "memory")
__device__ __forceinline__ unsigned long long rt() { return __builtin_amdgcn_s_memrealtime(); }
__device__ __forceinline__ unsigned f2bf(float f) { unsigned u = __builtin_bit_cast(unsigned, f); return (u + 0x7fffu + ((u >> 16) & 1u)) >> 16; }
__device__ __forceinline__ unsigned pk2(float lo, float hi) { return f2bf(lo) | (f2bf(hi) << 16); }

#define XB_TMO      128
#define XB_XCNT(j)  (256  + 64 * (j))
#define XB_XSUB(j)  (1280 + 64 * (j))
#define XB_XGEN(j)  (2304 + 64 * (j))
#define XB_TOP      3328
#define XB_TOPGEN   3392
#define XCD_BAR_WORDS 3456
#define XB_SPIN_CAP (1u << 18)

__device__ __forceinline__ unsigned xb_ld(unsigned* p)              { return __hip_atomic_load(p, __ATOMIC_RELAXED, __HIP_MEMORY_SCOPE_AGENT); }
__device__ __forceinline__ unsigned xb_add(unsigned* p, unsigned v) { return __hip_atomic_fetch_add(p, v, __ATOMIC_RELAXED, __HIP_MEMORY_SCOPE_AGENT); }
__device__ __forceinline__ unsigned xb_xcc_id() { return (unsigned)__builtin_amdgcn_s_getreg((3 << 11) | 20) & 0xFu; }
#define XB_SPIN(cond, bar) do { unsigned _sp = 0; while (cond) { __builtin_amdgcn_s_sleep(1); \
    if ((++_sp & 255u) == 0u) { if (xb_ld(&(bar)[XB_TMO])) break; if (_sp > XB_SPIN_CAP) { atomicAdd(&(bar)[XB_TMO], 1u); break; } } } } while (0)

struct XcdBarrier {
    unsigned* bar; unsigned x;
    volatile LAS unsigned* st;
};

__device__ __forceinline__ XcdBarrier xcd_barrier_post(unsigned* bar, volatile LAS unsigned* st) {
    XcdBarrier b; b.bar = bar; b.x = xb_xcc_id(); b.st = st;
    if (threadIdx.x == 0) (void)xb_add(&bar[XB_XCNT(b.x)], 1u);
    return b;
}
__device__ __forceinline__ void xcd_barrier_complete(unsigned* bar, unsigned x, unsigned& nloc, unsigned& nx) {
    const unsigned G = gridDim.x * gridDim.y * gridDim.z;
    unsigned sum, cnt, mine, sp = 0u;
    for (;;) {
        sum = 0u; cnt = 0u; mine = 0u;
#pragma unroll
        for (unsigned j = 0; j < 16; ++j) { const unsigned c = xb_ld(&bar[XB_XCNT(j)]); sum += c; cnt += (c > 0u) ? 1u : 0u; mine = (j == x) ? c : mine; }
        if (sum == G) break;
        __builtin_amdgcn_s_sleep(1);
        if ((++sp & 255u) == 0u) { if (xb_ld(&bar[XB_TMO])) break; if (sp > XB_SPIN_CAP) { atomicAdd(&bar[XB_TMO], 1u); break; } }
    }
    nloc = mine > 0u ? mine : 1u; nx = cnt > 0u ? cnt : 1u;
}

__device__ __forceinline__ void xcd_barrier(const XcdBarrier& b) {
    asm volatile("s_waitcnt vmcnt(0)" ::: "memory");
    __syncthreads();
    if (threadIdx.x == 0) {
        unsigned* bar = b.bar;
        __builtin_amdgcn_s_waitcnt(0);
        unsigned nloc = b.st[0], nx = b.st[1];
        if (nloc == 0u) { xcd_barrier_complete(bar, b.x, nloc, nx); b.st[0] = nloc; b.st[1] = nx; }
        const unsigned old = xb_add(&bar[XB_XSUB(b.x)], 1u);
        const unsigned gen = old / nloc;
        if (old + 1u == (gen + 1u) * nloc) {
            __builtin_amdgcn_fence(__ATOMIC_RELEASE, "agent");
            asm volatile("s_waitcnt vmcnt(0)" ::: "memory");
            const unsigned og = xb_add(&bar[XB_TOP], 1u);
            const unsigned tg = og / nx;
            if (og + 1u == (tg + 1u) * nx) xb_add(&bar[XB_TOPGEN], 1u);
            else XB_SPIN(xb_ld(&bar[XB_TOPGEN]) == tg, bar);
            __builtin_amdgcn_fence(__ATOMIC_ACQUIRE, "agent");
            xb_add(&bar[XB_XGEN(b.x)], 1u);
            asm volatile("s_waitcnt vmcnt(0)" ::: "memory");
        } else {
            XB_SPIN(xb_ld(&bar[XB_XGEN(b.x)]) == gen, bar);
            __builtin_amdgcn_fence(__ATOMIC_ACQUIRE, "agent");
            asm volatile("s_waitcnt vmcnt(0)" ::: "memory");
        }
    }
    __syncthreads();
}

constexpr int NWAVES = 8;
constexpr int D = 1024, MP = 4096, MS = 8192, M = MP + MS, NCOND = 9, NMOD = 6144, DFF = 2816;
constexpr int N_IN = 27;
constexpr float EPS = 1e-6f;
constexpr float LOG2E = 1.4426950408889634f;
constexpr float LAM_INIT = 0.35550906759f;
constexpr float ATT_C2 = 0.125f * 1.4426950408889634f;
enum { I_XP = 0, I_XS, I_SF, I_SB, I_CK, I_CV, I_C, I_CCTX, I_WADA, I_BADA, I_GMIX, I_GFFN, I_WIN, I_WG1, I_WG2, I_BG, I_GGH, I_WGO, I_WQKV, I_LQ, I_LK, I_GDH, I_WDO, I_WFG, I_WFU, I_WFD, I_GFIN };
constexpr size_t O_Y = 0, O_NSF = (size_t)M * D, O_NSB = O_NSF + 2097152, O_NCK = O_NSB + 2097152, O_NCV = O_NCK + 4194304, O_END = O_NCV + 4194304;
constexpr size_t MiB = 1u << 20;
constexpr size_t WS_CTL = 0, CTL_ZERO_BYTES = 1 * MiB;
constexpr size_t WS_MOD = 1 * MiB;
constexpr size_t WS_ROPE = 1 * MiB + 512 * 1024;
constexpr size_t WS_G1 = 2 * MiB;
constexpr size_t WS_WIN = 4 * MiB;
constexpr size_t WS_WGO = 11 * MiB;
constexpr size_t WS_WQKV = 13 * MiB;
constexpr size_t WS_WDO = 19 * MiB;
constexpr size_t WS_WUP = 21 * MiB;
constexpr size_t WS_WDN = 43 * MiB;
constexpr size_t WS_XN = 54 * MiB;
constexpr size_t WS_Z = 78 * MiB;
constexpr size_t WS_Q = 78 * MiB, WS_KB = 102 * MiB, WS_VB = 134 * MiB;
constexpr size_t WS_ACT = 166 * MiB;
constexpr size_t WS_OF = 166 * MiB, WS_OB = 190 * MiB;
constexpr size_t WS_END = 232 * MiB;
constexpr int CW_TMO = 0, CW_BAR = 4096;

constexpr int RING_OFF = 0, RING_BYTES = 131072;
constexpr int LDSCTL_OFF = RING_BYTES, MISC_OFF = LDSCTL_OFF + 320;
constexpr int LDS_BYTES = 147456;

typedef float f32x2 __attribute__((ext_vector_type(2)));
typedef float f32x16 __attribute__((ext_vector_type(16)));
typedef unsigned u32x2 __attribute__((ext_vector_type(2)));
typedef short s16x4 __attribute__((ext_vector_type(4)));
#define SYNC() __syncthreads()

struct Frame {
    LAS unsigned char* lds;
    volatile LAS unsigned* MISC;
    gu32* ctl;
    int tid, lane, wave, vcu, G;
    const float* in[N_IN];
    float* out; unsigned char* ws;
};
__device__ __forceinline__ float wave_sum(float v) {
#pragma unroll
    for (int o = 1; o < 64; o <<= 1) v += __shfl_xor(v, o);
    return v;
}
__device__ __forceinline__ unsigned cvtpk(float lo, float hi) { typedef float f2 __attribute__((ext_vector_type(2))); typedef __bf16 b2 __attribute__((ext_vector_type(2))); f2 v = {lo, hi}; b2 b = __builtin_convertvector(v, b2); return __builtin_bit_cast(unsigned, b); }
__device__ __forceinline__ float bf2f(unsigned short b) { return __builtin_bit_cast(float, (unsigned)b << 16); }
__device__ __forceinline__ int crow(int r, int hi) { return (r & 3) + 8 * (r >> 2) + 4 * hi; }
__device__ __forceinline__ unsigned off_b(unsigned row, unsigned ch) { return 256u * row + 16u * (ch ^ (((row & 3) << 2) | ((row >> 2) & 3))); }
__device__ __forceinline__ unsigned rowrd(unsigned lane, unsigned row0, unsigned s) { return off_b(row0 + (lane & 31), 2 * s + (lane >> 5)); }
__device__ __forceinline__ unsigned trrd(unsigned lane, unsigned c, unsigned ks, unsigned t) {
    const unsigned h = lane >> 5, blk = (lane >> 4) & 1, q = (lane & 15) >> 2, p = lane & 3;
    return off_b(16 * ks + 8 * h + 4 * t + q, 4 * c + 2 * blk + (p >> 1)) + 8 * (p & 1);
}
__device__ __forceinline__ s16x4 vtr(const LAS unsigned char* p) { typedef short v4 __attribute__((ext_vector_type(4))); return __builtin_bit_cast(s16x4, __builtin_amdgcn_ds_read_tr16_b64_v4i16((LAS v4*)p)); }
__device__ __forceinline__ bf16x8 tr8(const LAS unsigned char* img, unsigned lane, unsigned c, unsigned ks) {
    const s16x4 lo = vtr(img + trrd(lane, c, ks, 0)), hi = vtr(img + trrd(lane, c, ks, 1));
    return (bf16x8){lo[0], lo[1], lo[2], lo[3], hi[0], hi[1], hi[2], hi[3]};
}
#define MFMA32(a, b, c) __builtin_amdgcn_mfma_f32_32x32x16_bf16((a), (b), (c), 0, 0, 0)

__device__ __forceinline__ int rowmap(int kind, int n) {
    if (kind == 1) return n < 2048 ? ((n & ~0x30) | ((n & 0x10) << 1) | ((n & 0x20) >> 1)) : n;
    if (kind == 2) return 8 * (n >> 2) + (n & 3);
    if (kind == 3) return 8 * (n >> 2) + 4 + (n & 3);
    return n;
}
__device__ __forceinline__ void p0_transpose_item(const float* W, int K, int N, bf16* WT, int kind, LAS float* scr, int item, int lane) {
    const int nblk = N / 32, kb = item / nblk, nb = item % nblk, k0 = 64 * kb, n0 = 32 * nb;
#pragma unroll 8
    for (int i = 0; i < 32; ++i) { const int kk = 2 * i + (lane >> 5); scr[kk * 33 + (lane & 31)] = W[(size_t)(k0 + kk) * N + n0 + (lane & 31)]; }
    LDS_WAIT(); asm volatile("" ::: "memory");
    const int c = lane & 7;
#pragma unroll
    for (int j = 0; j < 4; ++j) { const int n = (lane >> 3) + 8 * j; const LAS float* s = scr + (8 * c) * 33 + n;
        v4u o; o.x = cvtpk(s[0 * 33], s[1 * 33]); o.y = cvtpk(s[2 * 33], s[3 * 33]); o.z = cvtpk(s[4 * 33], s[5 * 33]); o.w = cvtpk(s[6 * 33], s[7 * 33]);
        *(GAS v4u*)(WT + (size_t)rowmap(kind, n0 + n) * K + k0 + 8 * c) = o; }
    LDS_WAIT(); asm volatile("" ::: "memory");
}
__device__ __forceinline__ void p0_adaln_item(Frame& F, int item) {
    const int L = item / 96, cg = item % 96;
    LAS float* SV = (LAS float*)(F.lds + RING_OFF);
    LAS float* RED = SV + 1024 * 12;
    for (int idx = F.tid; idx < NCOND * 1024; idx += NWAVES * 64) { const int j = idx >> 10, k = idx & 1023;
        const float c = j == 0 ? F.in[I_CCTX][k] : F.in[I_C][(j - 1) * 1024 + k];
        SV[k * 12 + j] = c * __builtin_amdgcn_rcpf(1.0f + __builtin_amdgcn_exp2f(-LOG2E * c)); }
    SYNC();
    const float* W = F.in[I_WADA] + (size_t)L * 1024 * NMOD + cg * 64 + 4 * (F.tid & 15);
    const int kq = F.tid >> 4;
    f32x4 a[NCOND];
#pragma unroll
    for (int j = 0; j < NCOND; ++j) a[j] = (f32x4){0.f, 0.f, 0.f, 0.f};
#pragma unroll 4
    for (int kk = 0; kk < 32; ++kk) { const int k = kq + 32 * kk; const f32x4 w = *(const GAS f32x4*)(W + (size_t)k * NMOD);
        const f32x4 s0 = *(const LAS f32x4*)(SV + k * 12), s1 = *(const LAS f32x4*)(SV + k * 12 + 4); const float s2 = SV[k * 12 + 8];
        a[0] += w * s0[0]; a[1] += w * s0[1]; a[2] += w * s0[2]; a[3] += w * s0[3]; a[4] += w * s1[0]; a[5] += w * s1[1]; a[6] += w * s1[2]; a[7] += w * s1[3]; a[8] += w * s2; }
#pragma unroll
    for (int j = 0; j < NCOND; ++j)
#pragma unroll
        for (int e = 0; e < 4; ++e) { float v = a[j][e]; v += __shfl_xor(v, 16); v += __shfl_xor(v, 32); a[j][e] = v; }
    if (F.lane < 16) {
#pragma unroll
        for (int j = 0; j < NCOND; ++j) *(LAS f32x4*)(RED + (F.wave * NCOND + j) * 64 + 4 * F.lane) = a[j]; }
    SYNC();
    for (int idx = F.tid; idx < NCOND * 64; idx += NWAVES * 64) { const int j = idx >> 6, col = idx & 63; float s = 0.f;
#pragma unroll
        for (int w = 0; w < NWAVES; ++w) s += RED[(w * NCOND + j) * 64 + col];
        ((float*)(F.ws + WS_MOD))[(size_t)(L * NCOND + j) * NMOD + cg * 64 + col] = s + F.in[I_BADA][L * NMOD + cg * 64 + col]; }
    SYNC();
}
__device__ __forceinline__ void p0_prologue(Frame& F) {
    for (int it = F.vcu; it < 2 * 96; it += F.G) p0_adaln_item(F, it);
    for (int idx = F.vcu * NWAVES * 64 + F.tid; idx < 1024 * 32; idx += F.G * NWAVES * 64) { const int t = idx >> 5, e = idx & 31;
        const float inv = __builtin_amdgcn_exp2f(-(float)(e & 15) * (13.287712379549449f / 16.0f)); const float pos = (float)(e < 16 ? (t >> 6) : (t & 63));
        const float ang = pos * inv, rev = ang * 0.15915494309189535f, fr = rev - __builtin_floorf(rev);
        ((float*)(F.ws + WS_ROPE))[idx] = __builtin_amdgcn_cosf(fr); ((float*)(F.ws + WS_ROPE))[1024 * 32 + idx] = __builtin_amdgcn_sinf(fr); }
    { bf16* WT = (bf16*)(F.ws + WS_WIN) + (size_t)3072 * 1024;
      for (int idx = F.vcu * NWAVES * 64 + F.tid; idx < 256 * 1024; idx += F.G * NWAVES * 64) { const int row = idx >> 10, k = idx & 1023;
          const float v = row < 32 ? F.in[I_WG1][(size_t)(row >> 4) * 1024 * 16 + (size_t)k * 16 + (row & 15)] : 0.f; WT[idx] = (bf16)(cvtpk(v, 0.f) & 0xffffu); } }
    LAS float* scr = (LAS float*)(F.lds + RING_OFF + F.wave * 16384);
    const int gw = F.vcu * NWAVES + F.wave, NGW = F.G * NWAVES;
    constexpr int I_A = 16 * 96, I_B = 16 * 32, I_F = 16 * 88, I_DN = 44 * 32;
    constexpr int NITEMS = 2 * I_A + 2 * I_B + 4 * I_F + 2 * I_DN;
    for (int it = gw; it < NITEMS; it += NGW) {
        int r = it;
        if (r < I_A) { p0_transpose_item(F.in[I_WIN], 1024, 3072, (bf16*)(F.ws + WS_WIN), 0, scr, r, F.lane); continue; } r -= I_A;
        if (r < I_A) { p0_transpose_item(F.in[I_WQKV], 1024, 3072, (bf16*)(F.ws + WS_WQKV), 1, scr, r, F.lane); continue; } r -= I_A;
        if (r < I_B) { p0_transpose_item(F.in[I_WGO], 1024, 1024, (bf16*)(F.ws + WS_WGO), 0, scr, r, F.lane); continue; } r -= I_B;
        if (r < I_B) { p0_transpose_item(F.in[I_WDO], 1024, 1024, (bf16*)(F.ws + WS_WDO), 0, scr, r, F.lane); continue; } r -= I_B;
        if (r < 4 * I_F) { const int q = r / I_F, L = q & 1, up = q >> 1;
            p0_transpose_item(F.in[up ? I_WFU : I_WFG] + (size_t)L * 1024 * DFF, 1024, DFF, (bf16*)(F.ws + WS_WUP) + (size_t)L * 5632 * 1024, up ? 3 : 2, scr, r % I_F, F.lane); continue; } r -= 4 * I_F;
        { const int L = r / I_DN; p0_transpose_item(F.in[I_WFD] + (size_t)L * DFF * 1024, DFF, 1024, (bf16*)(F.ws + WS_WDN) + (size_t)L * 1024 * DFF, 0, scr, r % I_DN, F.lane); }
    }
}

__device__ __forceinline__ void norm_mod_phase(Frame& F, const float* xp, const float* xs, const float* g, const float* mod_shift, const float* mod_scale) {
    const int gw = F.vcu * NWAVES + F.wave, NGW = F.G * NWAVES;
    bf16* XN = (bf16*)(F.ws + WS_XN);
    for (int m = gw; m < M; m += NGW) {
        const float* xrow = m < MP ? xp + (size_t)m * D : xs + (size_t)(m - MP) * D; const int cond = m < MP ? 0 : 1 + ((m - MP) >> 10);
        const GAS f32x4* xr = (const GAS f32x4*)xrow + F.lane; f32x4 v[4]; float s = 0.f;
#pragma unroll
        for (int j = 0; j < 4; ++j) { v[j] = xr[64 * j]; s += (v[j].x * v[j].x + v[j].y * v[j].y) + (v[j].z * v[j].z + v[j].w * v[j].w); }
        const float rstd = 1.0f / sqrtf(wave_sum(s) * (1.f / D) + EPS);
        GAS u32x2* o8 = (GAS u32x2*)(XN + (size_t)m * D) + F.lane;
#pragma unroll
        for (int j = 0; j < 4; ++j) { const int c = 4 * (F.lane + 64 * j);
            const f32x4 gg = *(const GAS f32x4*)(g + c), sc = *(const GAS f32x4*)(mod_scale + (size_t)cond * NMOD + c), sh = *(const GAS f32x4*)(mod_shift + (size_t)cond * NMOD + c);
            const f32x4 y = (v[j] * rstd) * gg * (sc + 1.0f) + sh; u32x2 w; w.x = cvtpk(y.x, y.y); w.y = cvtpk(y.z, y.w); o8[64 * j] = w; }
    }
}
__device__ __forceinline__ void cache_convert_phase(Frame& F) {
    const int gw = F.vcu * NWAVES + F.wave, NGW = F.G * NWAVES;
    for (int i = gw; i < 2 * 4096; i += NGW) { const int kv = i >> 12, r = i & 4095, b = r >> 9, j = r & 511;
        const GAS f32x4* src = (const GAS f32x4*)(F.in[kv ? I_CV : I_CK] + (size_t)r * D) + F.lane;
        GAS u32x2* dst = (GAS u32x2*)((bf16*)(F.ws + (kv ? WS_VB : WS_KB)) + ((size_t)4096 + (size_t)b * 1536 + j) * D) + F.lane;
#pragma unroll
        for (int q = 0; q < 4; ++q) { const f32x4 v = src[64 * q]; u32x2 w; w.x = cvtpk(v.x, v.y); w.y = cvtpk(v.z, v.w); dst[64 * q] = w; } }
}
__device__ __forceinline__ void final_norm_phase(Frame& F) {
    const int gw = F.vcu * NWAVES + F.wave, NGW = F.G * NWAVES; const float* g = F.in[I_GFIN];
    for (int m = gw; m < M; m += NGW) { GAS f32x4* xr = (GAS f32x4*)(F.out + (size_t)m * D) + F.lane; f32x4 v[4]; float s = 0.f;
#pragma unroll
        for (int j = 0; j < 4; ++j) { v[j] = xr[64 * j]; s += (v[j].x * v[j].x + v[j].y * v[j].y) + (v[j].z * v[j].z + v[j].w * v[j].w); }
        const float rstd = 1.0f / sqrtf(wave_sum(s) * (1.f / D) + EPS);
#pragma unroll
        for (int j = 0; j < 4; ++j) { const f32x4 gg = *(const GAS f32x4*)(g + 4 * (F.lane + 64 * j)); xr[64 * j] = (v[j] * rstd) * gg; } }
}
__device__ __forceinline__ void gla_combine_phase(Frame& F) {
    const int gw = F.vcu * NWAVES + F.wave, NGW = F.G * NWAVES;
    const bf16* OF = (const bf16*)(F.ws + WS_OF); const bf16* OB = (const bf16*)(F.ws + WS_OB); const bf16* Z = (const bf16*)(F.ws + WS_Z); bf16* OG = (bf16*)(F.ws + WS_XN);
    const f32x4 gh = *(const GAS f32x4*)(F.in[I_GGH] + 4 * F.lane);
    for (int m = gw; m < M; m += NGW) {
#pragma unroll
        for (int h = 0; h < 4; ++h) { const int c = h * 256 + 4 * F.lane;
            const u32x2 a = *(const GAS u32x2*)(OF + (size_t)m * D + c), b = *(const GAS u32x2*)(OB + (size_t)m * D + c), r = *(const GAS u32x2*)(Z + (size_t)m * 3072 + 2048 + c);
            f32x4 o; o.x = bf2f(a.x & 0xffff) + bf2f(b.x & 0xffff); o.y = bf2f(a.x >> 16) + bf2f(b.x >> 16); o.z = bf2f(a.y & 0xffff) + bf2f(b.y & 0xffff); o.w = bf2f(a.y >> 16) + bf2f(b.y >> 16);
            f32x4 rr; rr.x = bf2f(r.x & 0xffff); rr.y = bf2f(r.x >> 16); rr.z = bf2f(r.y & 0xffff); rr.w = bf2f(r.y >> 16);
            const float ss = wave_sum((o.x * o.x + o.y * o.y) + (o.z * o.z + o.w * o.w)); const float rstd = 1.0f / sqrtf(ss * (1.f / 256.f) + EPS);
            f32x4 y;
#pragma unroll
            for (int e = 0; e < 4; ++e) y[e] = o[e] * rstd * gh[e] * (rr[e] * __builtin_amdgcn_rcpf(1.0f + __builtin_amdgcn_exp2f(-LOG2E * rr[e])));
            u32x2 w; w.x = cvtpk(y.x, y.y); w.y = cvtpk(y.z, y.w); *(GAS u32x2*)(OG + (size_t)m * D + c) = w; } }
}

constexpr int GL_QD = 0, GL_KD = 16384, GL_VV = 32768, GL_ST = 49152, GL_AM = 81920, GL_BF = 90112, GL_G1S = 123904, GL_SEGT = 128000, GL_DEC = 130048, GL_END = 130560;
static_assert(GL_END <= RING_BYTES, "gla lds");
constexpr float GLA_DKS = 0.08838834764831845f;

__device__ __forceinline__ void gla_item(Frame& F, int stype, int b, int h, int dir, int sl) {
    LAS unsigned char* L = F.lds + RING_OFF;
    const int tid = F.tid, lane = F.lane, wave = F.wave, r32 = lane & 31, hi = lane >> 5;
    const int T = stype ? 1024 : 256, NCH = T / 64, R0 = stype ? MP + b * 1024 : b * 256;
    const bf16* Z = (const bf16*)(F.ws + WS_Z); const float* G1 = (const float*)(F.ws + WS_G1);
    bf16* OD = (bf16*)(F.ws + (dir ? WS_OB : WS_OF));
    const int a_blk = wave >> 1, c0 = 2 * (wave & 1);
    f32x16 S[2];
    if (stype) { const float* st = F.in[dir ? I_SB : I_SF] + ((size_t)(b * 4 + h) * 128) * 256 + sl * 128;
#pragma unroll
        for (int ci = 0; ci < 2; ++ci)
#pragma unroll
            for (int r = 0; r < 16; ++r) S[ci][r] = st[(size_t)(32 * a_blk + crow(r, hi)) * 256 + 32 * (c0 + ci) + r32];
    } else { S[0] = f32x16{}; S[1] = f32x16{}; }
    const int dk_la = tid & 127, seg = tid >> 7;
    float w2[16];
#pragma unroll
    for (int r = 0; r < 16; ++r) w2[r] = F.in[I_WG2][(size_t)(dir * 16 + r) * 512 + h * 128 + dk_la];
    const float bg = F.in[I_BG][dir * 512 + h * 128 + dk_la];
    const int pi = tid >> 3, po = tid & 7;
    const int tb = wave >> 2, cc = wave & 3;
    unsigned rof[8], tr_o[2], tr_a[2], tr_v0[2], tr_v1[2];
    { const unsigned X = ((r32 & 3) << 2) | ((r32 >> 2) & 3);
#pragma unroll
      for (int s_ = 0; s_ < 8; ++s_) rof[s_] = 256u * r32 + 16u * ((2u * s_ + hi) ^ X);
      const unsigned blk = (lane >> 4) & 1, q = (lane & 15) >> 2, p = lane & 3;
#pragma unroll
      for (int t_ = 0; t_ < 2; ++t_) { const unsigned bt = 2048u * hi + 256u * q + 8u * (p & 1) + 1024u * t_ + 16u * ((2u * blk + (p >> 1)) ^ ((2u * hi + t_) & 3u));
          tr_o[t_] = bt + 64u * ((unsigned)cc ^ q); tr_a[t_] = bt + 64u * ((unsigned)a_blk ^ q); tr_v0[t_] = bt + 64u * ((unsigned)c0 ^ q); tr_v1[t_] = bt + 64u * ((unsigned)(c0 + 1) ^ q); } }
#define RD(img, row0, s_) (*(const LAS bf16x8*)(L + (img) + 256 * (row0) + rof[s_]))
#define TR8(dst, img, tab, ks_) do { const s16x4 lo_ = vtr(L + (img) + 4096 * (ks_) + tab[0]), hi_ = vtr(L + (img) + 4096 * (ks_) + tab[1]); dst = (bf16x8){lo_[0], lo_[1], lo_[2], lo_[3], hi_[0], hi_[1], hi_[2], hi_[3]}; } while (0)
    bf16x8 qv[2], kv[2], vv[2]; f32x2 g1v;
#define GLA_LOAD(n) do { const int i0_ = 64 * (n); \
        { const int t_ = dir ? T - 1 - (i0_ + pi) : i0_ + pi; const bf16* zr = Z + (size_t)(R0 + t_) * 3072 + h * 128 + 8 * po; \
          qv[0] = *(const GAS bf16x8*)zr; qv[1] = *(const GAS bf16x8*)(zr + 64); kv[0] = *(const GAS bf16x8*)(zr + 512); kv[1] = *(const GAS bf16x8*)(zr + 576); \
          g1v = *(const GAS f32x2*)(G1 + (size_t)(R0 + t_) * 32 + dir * 16 + 2 * po); } \
        _Pragma("unroll") for (int k_ = 0; k_ < 2; ++k_) { const int n_ = tid + 512 * k_, row_ = n_ >> 4, ch_ = n_ & 15; const int t_ = dir ? T - 1 - (i0_ + row_) : i0_ + row_; \
          vv[k_] = *(const GAS bf16x8*)(Z + (size_t)(R0 + t_) * 3072 + 1024 + h * 256 + sl * 128 + 8 * ch_); } } while (0)
    GLA_LOAD(0);
#define GLA_WRITE_ST() do { _Pragma("unroll") for (int ci = 0; ci < 2; ++ci) _Pragma("unroll") for (int g = 0; g < 4; ++g) { u32x2 w; w.x = cvtpk(S[ci][4 * g], S[ci][4 * g + 1]); w.y = cvtpk(S[ci][4 * g + 2], S[ci][4 * g + 3]); \
        *(LAS u32x2*)(L + GL_ST + off_b(32 * (c0 + ci) + r32, 4 * a_blk + g) + 8 * hi) = w; } } while (0)
    SYNC();
    GLA_WRITE_ST();
    for (int n = 0; n < NCH; ++n) {
        SYNC();
#pragma unroll
        for (int k = 0; k < 2; ++k) { const int nn = tid + 512 * k; *(LAS bf16x8*)(L + GL_VV + off_b(nn >> 4, nn & 15)) = vv[k]; }
        *(LAS f32x2*)(L + GL_G1S + (pi * 16 + 2 * po) * 4) = g1v;
        SYNC();
        float loc[16];
        { float run = 0.f; const LAS float* gs = (const LAS float*)(L + GL_G1S) + (16 * seg) * 16;
#pragma unroll
          for (int ii = 0; ii < 16; ++ii) { const f32x4 g0 = *(const LAS f32x4*)(gs + ii * 16), g1 = *(const LAS f32x4*)(gs + ii * 16 + 4), g2 = *(const LAS f32x4*)(gs + ii * 16 + 8), g3 = *(const LAS f32x4*)(gs + ii * 16 + 12);
              float x = bg;
#pragma unroll
              for (int e = 0; e < 4; ++e) { x += g0[e] * w2[e]; x += g1[e] * w2[4 + e]; x += g2[e] * w2[8 + e]; x += g3[e] * w2[12 + e]; }
              const float x2 = x * LOG2E, ls2 = fminf(x2, 0.f) - __builtin_amdgcn_logf(1.0f + __builtin_amdgcn_exp2f(-fabsf(x2)));
              run += ls2 * (1.0f / 16.0f); loc[ii] = run; }
          ((LAS float*)(L + GL_SEGT))[seg * 128 + dk_la] = run; }
        SYNC();
        { const LAS float* sg = (const LAS float*)(L + GL_SEGT); const float s0 = sg[dk_la], s1 = sg[128 + dk_la], s2 = sg[256 + dk_la], s3 = sg[384 + dk_la];
          const float pre = seg == 0 ? 0.f : seg == 1 ? s0 : seg == 2 ? s0 + s1 : (s0 + s1) + s2;
          LAS float* bf = (LAS float*)(L + GL_BF) + (16 * seg) * 132 + dk_la;
#pragma unroll
          for (int ii = 0; ii < 16; ++ii) bf[ii * 132] = pre + loc[ii];
          if (seg == 0) ((LAS float*)(L + GL_DEC))[dk_la] = __builtin_amdgcn_exp2f(((s0 + s1) + s2) + s3); }
        SYNC();
#pragma unroll
        for (int k = 0; k < 2; ++k) { const int oc = po + 8 * k; const LAS float* bp = (const LAS float*)(L + GL_BF) + pi * 132 + 8 * oc;
            const f32x4 b0 = *(const LAS f32x4*)bp, b1 = *(const LAS f32x4*)(bp + 4); float qd[8], kd[8];
#pragma unroll
            for (int j = 0; j < 8; ++j) { const float e = __builtin_amdgcn_exp2f(j < 4 ? b0[j & 3] : b1[j & 3]);
                qd[j] = bf2f((unsigned short)qv[k][j]) * (e * GLA_DKS); kd[j] = bf2f((unsigned short)kv[k][j]) * __builtin_amdgcn_rcpf(e); }
            v4u wq, wk; wq.x = cvtpk(qd[0], qd[1]); wq.y = cvtpk(qd[2], qd[3]); wq.z = cvtpk(qd[4], qd[5]); wq.w = cvtpk(qd[6], qd[7]);
            wk.x = cvtpk(kd[0], kd[1]); wk.y = cvtpk(kd[2], kd[3]); wk.z = cvtpk(kd[4], kd[5]); wk.w = cvtpk(kd[6], kd[7]);
            *(LAS v4u*)(L + GL_QD + off_b(pi, oc)) = wq; *(LAS v4u*)(L + GL_KD + off_b(pi, oc)) = wk; }
        SYNC();
        if (n + 1 < NCH) GLA_LOAD(n + 1);
        if (wave < 3) { const int sb = wave == 1 ? 1 : 0, tbt = wave == 0 ? 0 : 1; f32x16 at = f32x16{};
#pragma unroll
            for (int ks = 0; ks < 8; ++ks) { const bf16x8 ka = RD(GL_KD, 32 * sb, ks), qb = RD(GL_QD, 32 * tbt, ks); at = MFMA32(ka, qb, at); }
            if (sb == tbt) {
#pragma unroll
                for (int r = 0; r < 16; ++r) if (crow(r, hi) > r32) at[r] = 0.f; }
#pragma unroll
            for (int g = 0; g < 4; ++g) { u32x2 w; w.x = cvtpk(at[4 * g], at[4 * g + 1]); w.y = cvtpk(at[4 * g + 2], at[4 * g + 3]);
                *(LAS u32x2*)(L + GL_AM + off_b(r32, 8 * tbt + 4 * sb + g) + 8 * hi) = w; } }
        f32x16 oacc = f32x16{};
#pragma unroll
        for (int ks = 0; ks < 8; ++ks) { const bf16x8 qa = RD(GL_QD, 32 * tb, ks), sbf = RD(GL_ST, 32 * cc, ks); oacc = MFMA32(qa, sbf, oacc); }
        SYNC();
#pragma unroll
        for (int ks = 0; ks < 4; ++ks) if (tb || ks < 2) { const bf16x8 aa = tb ? RD(GL_AM, 0, 4 + ks) : RD(GL_AM, 0, ks); bf16x8 vb; TR8(vb, GL_VV, tr_o, ks); oacc = MFMA32(aa, vb, oacc); }
        { const int i0 = 64 * n + 32 * tb;
#pragma unroll
          for (int r = 0; r < 16; ++r) { const int i = i0 + crow(r, hi), t = dir ? T - 1 - i : i;
              OD[(size_t)(R0 + t) * D + h * 256 + sl * 128 + 32 * cc + r32] = (bf16)(cvtpk(oacc[r], 0.f) & 0xffffu); } }
#pragma unroll
        for (int ks = 0; ks < 4; ++ks) { bf16x8 ka, vb0, vb1;
            TR8(ka, GL_KD, tr_a, ks); TR8(vb0, GL_VV, tr_v0, ks); TR8(vb1, GL_VV, tr_v1, ks);
            S[0] = MFMA32(ka, vb0, S[0]); S[1] = MFMA32(ka, vb1, S[1]); }
        { const LAS float* dc = (const LAS float*)(L + GL_DEC) + 32 * a_blk;
#pragma unroll
          for (int r = 0; r < 16; ++r) { const float dv = dc[crow(r, hi)]; S[0][r] *= dv; S[1][r] *= dv; } }
        GLA_WRITE_ST();
    }
    if (!stype) { float* ns = F.out + (dir ? O_NSB : O_NSF) + ((size_t)(b * 4 + h) * 128) * 256 + sl * 128;
#pragma unroll
        for (int ci = 0; ci < 2; ++ci)
#pragma unroll
            for (int r = 0; r < 16; ++r) ns[(size_t)(32 * a_blk + crow(r, hi)) * 256 + 32 * (c0 + ci) + r32] = S[ci][r]; }
#undef GLA_LOAD
#undef RD
#undef TR8
#undef GLA_WRITE_ST
}
__device__ __forceinline__ void gla_phase(Frame& F) {
    const bool bal = (F.G == 256);
    const int n_it = bal ? (F.vcu < 128 ? 1 : 2) : (F.vcu < 384 ? (384 - F.vcu + F.G - 1) / F.G : 0);
    for (int i = 0; i < n_it; ++i) {
        const int it = bal ? (F.vcu < 128 ? F.vcu : 128 + 2 * (F.vcu - 128) + i) : F.vcu + i * F.G;
        const int stype = it < 128 ? 1 : 0, p = it < 128 ? it : it - 128;
        gla_item(F, stype, p >> 4, (p >> 2) & 3, (p >> 1) & 1, p & 1);
    }
    SYNC();
}

constexpr int AT_K = 0, AT_V = 32768, AT_WSF = 65536, AT_X = 0;
constexpr float AT_THR = 6.0f;
__device__ __forceinline__ void attn_unit(Frame& F, int stype, int b, int h, int qblk, float lam) {
    LAS unsigned char* L = F.lds + RING_OFF;
    const int lane = F.lane, wave = F.wave, r32 = lane & 31, hi = lane >> 5, qg = wave & 3, mp = wave >> 2;
    const int Tk = stype ? 1536 : 256, NT = Tk / 64;
    const size_t krow0 = stype ? (size_t)MP + (size_t)b * 1536 : (size_t)b * 256;
    const size_t qrow0 = (stype ? (size_t)MP + (size_t)b * 1024 : (size_t)b * 256) + qblk * 128;
    const bf16* Qb = (const bf16*)(F.ws + WS_Q); const bf16* KBp = (const bf16*)(F.ws + WS_KB) + krow0 * D + h * 128; const bf16* VBp = (const bf16*)(F.ws + WS_VB) + krow0 * D + h * 128;
    bf16* O = (bf16*)(F.ws + WS_XN);
    LAS float* wsf = (LAS float*)(L + AT_WSF) + wave * 64;
    const bf16* ksrc0 = KBp + (size_t)lane * D + (2 * wave) * 8;
    const bf16* vsrc0[2];
#pragma unroll
    for (int k = 0; k < 2; ++k) { const int p = 2 * wave + k, dq = p >> 2, rg = p & 3; vsrc0[k] = VBp + (size_t)(16 * rg + (lane >> 2)) * D + dq * 32 + (lane & 3) * 8; }
#define AT_DMA(t, slot) do { const size_t ro_ = (size_t)(t) * 64 * D; \
        __builtin_amdgcn_global_load_lds((const unsigned*)(ksrc0 + ro_), (LAS unsigned*)(L + AT_K + (slot) * 16384 + (2 * wave) * 1024), 16, 0, 0); \
        __builtin_amdgcn_global_load_lds((const unsigned*)(ksrc0 + ro_ + 8), (LAS unsigned*)(L + AT_K + (slot) * 16384 + (2 * wave + 1) * 1024), 16, 0, 0); \
        __builtin_amdgcn_global_load_lds((const unsigned*)(vsrc0[0] + ro_), (LAS unsigned*)(L + AT_V + (slot) * 16384 + (2 * wave) * 1024), 16, 0, 0); \
        __builtin_amdgcn_global_load_lds((const unsigned*)(vsrc0[1] + ro_), (LAS unsigned*)(L + AT_V + (slot) * 16384 + (2 * wave + 1) * 1024), 16, 0, 0); } while (0)
    SYNC();
    AT_DMA(0, 0);
    bf16x8 qr[4];
#pragma unroll
    for (int d0 = 0; d0 < 4; ++d0) qr[d0] = *(const GAS bf16x8*)(Qb + (qrow0 + 32 * qg + r32) * D + h * 128 + mp * 64 + 16 * d0 + 8 * hi);
    f32x16 o[4]; o[0] = f32x16{}; o[1] = f32x16{}; o[2] = f32x16{}; o[3] = f32x16{};
    float mhat = 0.f, l = 0.f; f32x16 negm = f32x16{};
    const unsigned vb0 = ((lane >> 4) & 1) * 32 + (lane & 3) * 8 + (4 * hi + ((lane & 15) >> 2)) * 64;
    for (int t = 0; t < NT; ++t) {
        SYNC();
        if (t + 1 < NT) AT_DMA(t + 1, (t + 1) & 1);
        const LAS unsigned char* Ks = L + AT_K + (t & 1) * 16384 + (8 * mp + hi) * 1024 + r32 * 16;
        const LAS unsigned char* Vs = L + AT_V + (t & 1) * 16384 + vb0;
        f32x16 p0 = negm, p1 = negm;
#pragma unroll
        for (int d0 = 0; d0 < 4; ++d0) { const bf16x8 k0 = *(const LAS bf16x8*)(Ks + d0 * 2048), k1 = *(const LAS bf16x8*)(Ks + d0 * 2048 + 512); p0 = MFMA32(k0, qr[d0], p0); p1 = MFMA32(k1, qr[d0], p1); }
        float rm = fmaxf(p0[0], p1[0]);
#pragma unroll
        for (int r = 1; r < 16; ++r) rm = fmaxf(rm, fmaxf(p0[r], p1[r]));
        { auto rr = __builtin_amdgcn_permlane32_swap(__float_as_uint(rm), __float_as_uint(rm), false, false); rm = fmaxf(__uint_as_float(rr[0]), __uint_as_float(rr[1])); }
        const bool first = (t == 0);
        if (first || __any(rm > AT_THR)) {
            const float dl = first ? rm : fmaxf(rm, 0.f); mhat += dl;
#pragma unroll
            for (int r = 0; r < 16; ++r) { p0[r] -= dl; p1[r] -= dl; negm[r] = -mhat; }
            if (!first) { const float f = __builtin_amdgcn_exp2f(-dl); l *= f; if (hi == 0) wsf[r32] = f;
                asm volatile("s_waitcnt lgkmcnt(0)" ::: "memory");
#pragma unroll
                for (int r = 0; r < 16; ++r) { const float fr = wsf[crow(r, hi)]; o[0][r] *= fr; o[1][r] *= fr; o[2][r] *= fr; o[3][r] *= fr; } }
        }
        float ls = 0.f;
#pragma unroll
        for (int r = 0; r < 16; ++r) { p0[r] = __builtin_amdgcn_exp2f(p0[r]); p1[r] = __builtin_amdgcn_exp2f(p1[r]); ls += p0[r] + p1[r]; }
        l += ls;
        v4u pw[4];
        pw[0] = (v4u){cvtpk(p0[0], p0[1]), cvtpk(p0[2], p0[3]), cvtpk(p0[4], p0[5]), cvtpk(p0[6], p0[7])};
        pw[1] = (v4u){cvtpk(p0[8], p0[9]), cvtpk(p0[10], p0[11]), cvtpk(p0[12], p0[13]), cvtpk(p0[14], p0[15])};
        pw[2] = (v4u){cvtpk(p1[0], p1[1]), cvtpk(p1[2], p1[3]), cvtpk(p1[4], p1[5]), cvtpk(p1[6], p1[7])};
        pw[3] = (v4u){cvtpk(p1[8], p1[9]), cvtpk(p1[10], p1[11]), cvtpk(p1[12], p1[13]), cvtpk(p1[14], p1[15])};
#pragma unroll
        for (int d0 = 0; d0 < 4; ++d0)
#pragma unroll
            for (int ks = 0; ks < 4; ++ks) { const s16x4 lo = vtr(Vs + d0 * 4096 + ks * 1024), hh = vtr(Vs + d0 * 4096 + ks * 1024 + 512);
                const bf16x8 vf = (bf16x8){lo[0], lo[1], lo[2], lo[3], hh[0], hh[1], hh[2], hh[3]};
                o[d0] = MFMA32(__builtin_bit_cast(bf16x8, pw[ks]), vf, o[d0]); }
    }
    { auto rr = __builtin_amdgcn_permlane32_swap(__float_as_uint(l), __float_as_uint(l), false, false); l = __uint_as_float(rr[0]) + __uint_as_float(rr[1]); }
    { const float f = (mp ? -lam : 1.0f) * __builtin_amdgcn_rcpf(l); if (hi == 0) wsf[r32] = f; asm volatile("s_waitcnt lgkmcnt(0)" ::: "memory");
#pragma unroll
      for (int r = 0; r < 16; ++r) { const float fr = wsf[crow(r, hi)]; o[0][r] *= fr; o[1][r] *= fr; o[2][r] *= fr; o[3][r] *= fr; } }
    SYNC();
    LAS float* X = (LAS float*)(L + AT_X) + qg * 4096;
    if (mp) {
#pragma unroll
        for (int d0 = 0; d0 < 4; ++d0)
#pragma unroll
            for (int r = 0; r < 16; ++r) X[(d0 * 16 + r) * 64 + lane] = o[d0][r]; }
    SYNC();
    if (!mp) {
#pragma unroll
        for (int d0 = 0; d0 < 4; ++d0)
#pragma unroll
            for (int r = 0; r < 16; ++r) o[d0][r] += X[(d0 * 16 + r) * 64 + lane];
        asm volatile("s_waitcnt lgkmcnt(0)" ::: "memory");
#pragma unroll
        for (int d0 = 0; d0 < 4; ++d0)
#pragma unroll
            for (int r = 0; r < 16; ++r) X[crow(r, hi) * 128 + 32 * d0 + r32] = o[d0][r];
        asm volatile("s_waitcnt lgkmcnt(0)" ::: "memory");
        const int sg = lane & 7;
        f32x4 gh[4];
#pragma unroll
        for (int q = 0; q < 4; ++q) gh[q] = *(const GAS f32x4*)(F.in[I_GDH] + 16 * sg + 4 * q);
#pragma unroll
        for (int ps = 0; ps < 4; ++ps) { const int row = ps * 8 + (lane >> 3); f32x4 v[4]; float ss = 0.f;
#pragma unroll
            for (int q = 0; q < 4; ++q) { v[q] = *(const LAS f32x4*)(X + row * 128 + 16 * sg + 4 * q); ss += (v[q].x * v[q].x + v[q].y * v[q].y) + (v[q].z * v[q].z + v[q].w * v[q].w); }
            ss += __shfl_xor(ss, 1); ss += __shfl_xor(ss, 2); ss += __shfl_xor(ss, 4);
            const float rs = (1.0f - LAM_INIT) / sqrtf(ss * (1.f / 128.f) + EPS);
            v4u w0, w1; f32x4 y[4];
#pragma unroll
            for (int q = 0; q < 4; ++q) y[q] = v[q] * rs * gh[q];
            w0 = (v4u){cvtpk(y[0].x, y[0].y), cvtpk(y[0].z, y[0].w), cvtpk(y[1].x, y[1].y), cvtpk(y[1].z, y[1].w)};
            w1 = (v4u){cvtpk(y[2].x, y[2].y), cvtpk(y[2].z, y[2].w), cvtpk(y[3].x, y[3].y), cvtpk(y[3].z, y[3].w)};
            bf16* op = O + (qrow0 + 32 * qg + row) * D + h * 128 + 16 * sg; *(GAS v4u*)op = w0; *(GAS v4u*)(op + 8) = w1; }
    }
#undef AT_DMA
}
__device__ __forceinline__ void attn_phase(Frame& F) {
    float s0 = 0.f, s1 = 0.f;
    for (int i = 0; i < 64; ++i) { s0 += F.in[I_LQ][i] * F.in[I_LK][i]; s1 += F.in[I_LQ][64 + i] * F.in[I_LK][64 + i]; }
    const float lam = __builtin_amdgcn_exp2f(LOG2E * s0) - __builtin_amdgcn_exp2f(LOG2E * s1) + LAM_INIT;
    for (int u = F.vcu; u < 768; u += F.G) {
        if (u < 512) { const int bh = u >> 3; attn_unit(F, 1, bh >> 3, bh & 7, u & 7, lam); }
        else { const int up = u - 512, bh = up >> 1; attn_unit(F, 0, bh >> 3, bh & 7, up & 1, lam); }
    }
    SYNC();
}

#ifndef MK_PER_PHASE
#define MK_PER_PHASE 0
#endif
#ifndef MK_MASK
#define MK_MASK 0x1ffff
#endif
constexpr int N_PHASES = 17;
struct Args { const float* in[N_IN]; float* out; unsigned char* ws; int ph_lo, ph_hi; };
__global__ void __launch_bounds__(NWAVES * 64, 2) mk_fwd(Args args) {
    extern __shared__ __attribute__((aligned(16))) unsigned char lds[];
    Frame F;
    F.lds = (LAS unsigned char*)lds;
    F.MISC = (volatile LAS unsigned*)(F.lds + MISC_OFF);
    F.tid = threadIdx.x; F.lane = F.tid & 63; F.wave = __builtin_amdgcn_readfirstlane(F.tid >> 6);
    F.G = gridDim.x; { const int bx = blockIdx.x; F.vcu = (F.G % 8 == 0) ? (bx % 8) * (F.G / 8) + bx / 8 : bx; }
#pragma unroll
    for (int i = 0; i < N_IN; ++i) F.in[i] = args.in[i];
    F.out = args.out; F.ws = args.ws; F.ctl = (gu32*)(args.ws + WS_CTL);
    for (int u = F.tid; u < (LDS_BYTES - LDSCTL_OFF) / 4; u += NWAVES * 64) ((LAS unsigned*)(F.lds + LDSCTL_OFF))[u] = 0u;
    __syncthreads();
    XcdBarrier bar; bar.bar = (unsigned*)(F.ctl + CW_BAR); bar.x = 0; bar.st = nullptr;
    if (!MK_PER_PHASE) bar = xcd_barrier_post((unsigned*)(F.ctl + CW_BAR), F.MISC + 8);
    const int lo = args.ph_lo, hi = args.ph_hi;
#define IN(k) (((MK_MASK >> (k)) & 1) && lo <= (k) && (k) < hi)
#define SEAM(k) do { if (IN(k) && IN((k) + 1)) xcd_barrier(bar); } while (0)
    bf16* const XN = (bf16*)(F.ws + WS_XN);
    const float* const MOD = (const float*)(F.ws + WS_MOD);
    float* const X = F.out;
    LAS unsigned char* const ring = F.lds + RING_OFF;
#define GEMM_PHASE(EpiT, Aptr, Bptr, Nn, Kk, Eobj) do { pg8::Gemm g{(const pg8::bf16_t*)(Aptr), (const pg8::bf16_t*)(Bptr), M, (Nn), (Kk)}; pg8::StaticOrder S; S.init(M, (Nn), F.G, (int)blockIdx.x); \
        pg8::gemm_phase<EpiT, pg8::StaticOrder, true, true>(ring, g, S, (Eobj)); } while (0)

    if (IN(0)) { p0_prologue(F); } SEAM(0);
    if (IN(1)) { norm_mod_phase(F, F.in[I_XP], F.in[I_XS], F.in[I_GMIX], MOD + 0 * 1024, MOD + 1 * 1024); } SEAM(1);
    if (IN(2)) { pg8::EpiInProj E{(pg8::bf16_t*)(F.ws + WS_Z), (float*)(F.ws + WS_G1)}; GEMM_PHASE(pg8::EpiInProj, XN, F.ws + WS_WIN, 3328, 1024, E); } SEAM(2);
    if (IN(3)) { gla_phase(F); } SEAM(3);
    if (IN(4)) { gla_combine_phase(F); } SEAM(4);
    if (IN(5)) { pg8::EpiRes E{F.in[I_XP], F.in[I_XS], X, MOD + 2 * 1024}; GEMM_PHASE(pg8::EpiRes, XN, F.ws + WS_WGO, 1024, 1024, E); } SEAM(5);
    if (IN(6)) { norm_mod_phase(F, X, X + (size_t)MP * D, F.in[I_GFFN], MOD + 3 * 1024, MOD + 4 * 1024); } SEAM(6);
    if (IN(7)) { pg8::EpiSwiglu E{(pg8::bf16_t*)(F.ws + WS_ACT)}; GEMM_PHASE(pg8::EpiSwiglu, XN, F.ws + WS_WUP, 5632, 1024, E); } SEAM(7);
    if (IN(8)) { pg8::EpiRes E{X, X + (size_t)MP * D, X, MOD + 5 * 1024}; GEMM_PHASE(pg8::EpiRes, F.ws + WS_ACT, F.ws + WS_WDN, 1024, DFF, E); } SEAM(8);
    const float* const MOD1 = MOD + (size_t)NCOND * NMOD;
    if (IN(9)) { norm_mod_phase(F, X, X + (size_t)MP * D, F.in[I_GMIX] + D, MOD1 + 0 * 1024, MOD1 + 1 * 1024); cache_convert_phase(F); } SEAM(9);
    if (IN(10)) { pg8::EpiQkv E{(pg8::bf16_t*)(F.ws + WS_Q), (pg8::bf16_t*)(F.ws + WS_KB), (pg8::bf16_t*)(F.ws + WS_VB), F.out + O_NCK, F.out + O_NCV,
                                (const float*)(F.ws + WS_ROPE), (const float*)(F.ws + WS_ROPE) + 1024 * 32, ATT_C2};
                  GEMM_PHASE(pg8::EpiQkv, XN, F.ws + WS_WQKV, 3072, 1024, E); } SEAM(10);
    if (IN(11)) { attn_phase(F); } SEAM(11);
    if (IN(12)) { pg8::EpiRes E{X, X + (size_t)MP * D, X, MOD1 + 2 * 1024}; GEMM_PHASE(pg8::EpiRes, XN, F.ws + WS_WDO, 1024, 1024, E); } SEAM(12);
    if (IN(13)) { norm_mod_phase(F, X, X + (size_t)MP * D, F.in[I_GFFN] + D, MOD1 + 3 * 1024, MOD1 + 4 * 1024); } SEAM(13);
    if (IN(14)) { pg8::EpiSwiglu E{(pg8::bf16_t*)(F.ws + WS_ACT)}; GEMM_PHASE(pg8::EpiSwiglu, XN, F.ws + WS_WUP + (size_t)5632 * 1024 * 2, 5632, 1024, E); } SEAM(14);
    if (IN(15)) { pg8::EpiRes E{X, X + (size_t)MP * D, X, MOD1 + 5 * 1024}; GEMM_PHASE(pg8::EpiRes, F.ws + WS_ACT, F.ws + WS_WDN + (size_t)1024 * DFF * 2, 1024, DFF, E); } SEAM(15);
    if (IN(16)) { final_norm_phase(F); }
#undef IN
#undef SEAM
#undef GEMM_PHASE
}

extern "C" void kernel_launch(void* const* d_in, const int* in_sizes, int n_in, void* d_out, int out_size, void* d_ws, size_t ws_size, hipStream_t stream) {
    static int grid = 0;
    if (grid == 0) {
        if (n_in != N_IN || (size_t)out_size != O_END || ws_size < WS_END) { fprintf(stderr, "kernel_launch: unexpected shapes (n_in %d, out %d, ws %zu); nothing launched\n", n_in, out_size, ws_size); grid = -1; return; }
        int dev = 0, cus = 0, per_cu = 0;
        if (hipGetDevice(&dev) != hipSuccess || hipDeviceGetAttribute(&cus, hipDeviceAttributeMultiprocessorCount, dev) != hipSuccess) { grid = -1; return; }
        if (hipFuncSetAttribute((const void*)mk_fwd, hipFuncAttributeMaxDynamicSharedMemorySize, LDS_BYTES) != hipSuccess) { fprintf(stderr, "kernel_launch: hipFuncSetAttribute failed\n"); grid = -1; return; }
        if (hipOccupancyMaxActiveBlocksPerMultiprocessor(&per_cu, (const void*)mk_fwd, NWAVES * 64, LDS_BYTES) != hipSuccess || per_cu < 1) { fprintf(stderr, "kernel_launch: occupancy query reports %d blocks per CU\n", per_cu); per_cu = 1; }
        (void)hipGetLastError();
        grid = cus;
        if (grid > 256) grid = 256;
    }
    if (grid < 0) return;
    (void)hipMemsetAsync((char*)d_ws + WS_CTL, 0, CTL_ZERO_BYTES, stream);
    Args a{};
    for (int i = 0; i < N_IN; ++i) a.in[i] = (const float*)d_in[i];
    a.out = (float*)d_out; a.ws = (unsigned char*)d_ws;
#if MK_PER_PHASE
    for (int p = 0; p < N_PHASES; ++p) { a.ph_lo = p; a.ph_hi = p + 1; hipLaunchKernelGGL(mk_fwd, dim3(grid), dim3(NWAVES * 64), LDS_BYTES, stream, a); }
#else
    a.ph_lo = 0; a.ph_hi = N_PHASES;
    hipLaunchKernelGGL(mk_fwd, dim3(grid), dim3(NWAVES * 64), LDS_BYTES, stream, a);
#endif
}
```
